# Optimizing an MI355X kernel written in HIP

```python
import jax, jax.numpy as jnp
from jax import lax
import numpy as np

D_MODEL = 1024
BATCH = 2
SEQ = 8192
DEPTH = 2

N_A_LAYERS = DEPTH // 2
N_B_LAYERS = DEPTH - N_A_LAYERS
N_DENSE = (DEPTH + 1) // 2
N_MOE = DEPTH // 2

DN_HEADS = 8
DN_DK = 128
DN_DV = 128
DN_CONV = 4
DN_CHUNK = 64

SW_Q_HEADS = 16
SW_KV_HEADS = 4
SW_HEAD_DIM = 64
SW_WINDOW = 128
SW_BLOCK = 128

D_FF = 2816
N_EXPERTS = 8
TOP_K = 2
D_EXPERT = 2816

DEEP_ALPHA = (2 * DEPTH) ** 0.25
DEEP_BETA = (8 * DEPTH) ** -0.25
LN_EPS = 1e-5
RMS_EPS = 1e-6

kernel_name = "yoco_deltanet_swa_sink_alibi_moe_deepnorm"


def layer_norm(x, g, b):
    xf = x.astype(jnp.float32)
    mu = jnp.mean(xf, axis=-1, keepdims=True)
    xc = xf - mu
    var = jnp.mean(xc * xc, axis=-1, keepdims=True)
    y = xc * lax.rsqrt(var + LN_EPS) * g.astype(jnp.float32) + b.astype(jnp.float32)
    return y.astype(x.dtype)


def l2_normalize(a):
    return a * lax.rsqrt(jnp.sum(a * a, axis=-1, keepdims=True) + RMS_EPS)


def causal_short_conv(x, w):
    K = w.shape[0]
    T = x.shape[1]
    xp = jnp.pad(x, ((0, 0), (K - 1, 0), (0, 0)))
    return sum(xp[:, i:i + T] * w[i] for i in range(K))


def gated_delta_chunked(q, k, v, g, beta):
    B_, T, H, dk = q.shape
    dv = v.shape[-1]
    C = DN_CHUNK
    N = T // C

    def chunks(a):
        a = a.reshape((B_, N, C, H) + a.shape[3:])
        return jnp.moveaxis(a, 3, 1)

    q, k, v, g, beta = chunks(q), chunks(k), chunks(v), chunks(g), chunks(beta)
    G = jnp.cumsum(g, axis=-1)
    idx = jnp.arange(C)
    incl = idx[:, None] >= idx[None, :]
    strict = idx[:, None] > idx[None, :]
    decay = jnp.exp(jnp.where(incl, G[..., :, None] - G[..., None, :], -jnp.inf))

    kb = k * beta[..., None]
    vb = v * beta[..., None]
    L = jnp.where(strict, jnp.einsum('bhncd,bhnsd->bhncs', kb, k) * decay, 0.0)
    eye = jnp.eye(C, dtype=q.dtype)
    rhs = jnp.concatenate([vb, kb * jnp.exp(G)[..., None]], axis=-1)
    sol = lax.linalg.triangular_solve(eye + L, rhs, left_side=True, lower=True,
                                      unit_diagonal=True)
    U = sol[..., :dv]
    W = sol[..., dv:]

    Aqk = jnp.einsum('bhncd,bhnsd->bhncs', q, k) * decay
    qg = q * jnp.exp(G)[..., None]
    kdec = k * jnp.exp(G[..., -1:] - G)[..., None]
    glast = jnp.exp(G[..., -1])

    xs = tuple(jnp.moveaxis(a, 2, 0) for a in (U, W, qg, Aqk, kdec, glast))

    def step(S, inp):
        u, w, qc, aqk, kd, gl = inp
        v_new = u - jnp.einsum('bhck,bhkv->bhcv', w, S)
        o = jnp.einsum('bhck,bhkv->bhcv', qc, S) + jnp.einsum('bhcs,bhsv->bhcv', aqk, v_new)
        S = S * gl[..., None, None] + jnp.einsum('bhck,bhcv->bhkv', kd, v_new)
        return S, o

    S0 = jnp.zeros((B_, H, dk, dv), q.dtype)
    _, o = lax.scan(step, S0, xs)
    return o.transpose(1, 0, 3, 2, 4).reshape(B_, T, H, dv)


def deltanet_mixer(x, w_in, conv_w, a_log, dt_bias, norm_w, w_out):
    B_, T, _ = x.shape
    H, dk, dv = DN_HEADS, DN_DK, DN_DV
    proj = x @ w_in
    n_qkv = 2 * H * dk + H * dv
    qkv = proj[..., :n_qkv]
    z = proj[..., n_qkv:n_qkv + H * dv]
    b_logit = proj[..., n_qkv + H * dv:n_qkv + H * dv + H]
    a_logit = proj[..., n_qkv + H * dv + H:]
    qkv = jax.nn.silu(causal_short_conv(qkv, conv_w)).astype(jnp.float32)
    q = qkv[..., :H * dk].reshape(B_, T, H, dk)
    k = qkv[..., H * dk:2 * H * dk].reshape(B_, T, H, dk)
    v = qkv[..., 2 * H * dk:].reshape(B_, T, H, dv)
    q = l2_normalize(q) * (dk ** -0.5)
    k = l2_normalize(k)
    beta = jax.nn.sigmoid(b_logit.astype(jnp.float32))
    g = -jnp.exp(a_log.astype(jnp.float32)) * jax.nn.softplus(
        a_logit.astype(jnp.float32) + dt_bias.astype(jnp.float32))
    o = gated_delta_chunked(q, k, v, g, beta)
    o = o * lax.rsqrt(jnp.mean(o * o, axis=-1, keepdims=True) + RMS_EPS) * norm_w.astype(jnp.float32)
    o = o * jax.nn.silu(z.reshape(B_, T, H, dv).astype(jnp.float32))
    return o.reshape(B_, T, H * dv).astype(x.dtype) @ w_out


def shared_kv(x, w_kv):
    B_, T, _ = x.shape
    kv = x @ w_kv
    n = SW_KV_HEADS * SW_HEAD_DIM
    k = kv[..., :n].reshape(B_, T, SW_KV_HEADS, SW_HEAD_DIM)
    v = kv[..., n:].reshape(B_, T, SW_KV_HEADS, SW_HEAD_DIM)
    return k, v


def alibi_slopes(n):
    return 2.0 ** (-8.0 * jnp.arange(1, n + 1, dtype=jnp.float32) / n)


def sliding_window_mixer(x, k_sh, v_sh, w_q, sinks, w_out):
    B_, T, _ = x.shape
    Hq, Hk, hd = SW_Q_HEADS, SW_KV_HEADS, SW_HEAD_DIM
    G = Hq // Hk
    W = SW_BLOCK
    nb = T // W
    q = (x @ w_q).astype(jnp.float32).reshape(B_, nb, W, Hk, G, hd) * (hd ** -0.5)

    def band(a):
        a = a.astype(jnp.float32)
        ap = jnp.pad(a, ((0, 0), (W, 0), (0, 0), (0, 0)))
        prev = ap[:, :T].reshape(B_, nb, W, Hk, hd)
        cur = a.reshape(B_, nb, W, Hk, hd)
        return jnp.concatenate([prev, cur], axis=2)

    kb, vb = band(k_sh), band(v_sh)
    s = jnp.einsum('bnqkgd,bnskd->bnkgqs', q, kb)
    qi = jnp.arange(W)
    sj = jnp.arange(2 * W)
    dist = qi[:, None] + W - sj[None, :]
    kpos = jnp.arange(nb)[:, None] * W - W + sj[None, :]
    valid = ((dist >= 0) & (dist < SW_WINDOW))[None] & (kpos >= 0)[:, None, :]
    slopes = alibi_slopes(Hq).reshape(Hk, G)
    s = s - slopes[:, :, None, None] * dist.astype(jnp.float32)
    s = jnp.where(valid[None, :, None, None], s, -jnp.inf)
    sink = sinks.astype(jnp.float32).reshape(Hk, G)[:, :, None, None]
    m = jnp.maximum(jnp.max(s, axis=-1, keepdims=True), sink)
    p = jnp.exp(s - m)
    p = p / (jnp.sum(p, axis=-1, keepdims=True) + jnp.exp(sink - m))
    o = jnp.einsum('bnkgqs,bnskd->bnqkgd', p, vb).reshape(B_, T, Hq * hd)
    return o.astype(x.dtype) @ w_out


def dense_swiglu(x, w_gu, w_down):
    h = x @ w_gu
    gate, up = h[..., :D_FF], h[..., D_FF:]
    return (jax.nn.silu(gate) * up) @ w_down


def moe_swiglu(x, w_router, w_gu, w_down):
    B_, T, D = x.shape
    xt = x.reshape(-1, D)
    logits = (xt @ w_router).astype(jnp.float32)
    top_v, top_i = lax.top_k(logits, TOP_K)
    top_w = jax.nn.softmax(top_v, axis=-1)
    gates = jnp.sum(jax.nn.one_hot(top_i, N_EXPERTS, dtype=jnp.float32) * top_w[..., None], axis=1)
    out = jnp.zeros_like(xt)
    for e in range(N_EXPERTS):
        h = xt @ w_gu[e]
        y = (jax.nn.silu(h[:, :D_EXPERT]) * h[:, D_EXPERT:]) @ w_down[e]
        out = out + gates[:, e:e + 1].astype(xt.dtype) * y
    return out.reshape(B_, T, D)


def setup_inputs(seed: int = 0) -> dict:
    key = jax.random.key(seed)
    ks = jax.random.split(key, 20)
    f32 = jnp.float32
    D = D_MODEL

    def nrm(k, shape, scale):
        return jax.random.normal(k, shape, f32) * scale

    dn_in_width = 2 * DN_HEADS * DN_DK + 2 * DN_HEADS * DN_DV + 2 * DN_HEADS
    dt = jnp.exp(jax.random.uniform(ks[3], (N_A_LAYERS, DN_HEADS), f32,
                                    math_log(1e-3), math_log(1e-1)))
    dt_bias = dt + jnp.log(-jnp.expm1(-dt))
    n_kv = SW_KV_HEADS * SW_HEAD_DIM
    w_k = nrm(ks[7], (D, n_kv), D ** -0.5)
    w_v = nrm(ks[8], (D, n_kv), D ** -0.5 * DEEP_BETA)
    return {
        "x": jax.random.normal(ks[0], (BATCH, SEQ, D), f32),
        "dn_w_in": nrm(ks[1], (N_A_LAYERS, D, dn_in_width), D ** -0.5),
        "dn_conv_w": nrm(ks[2], (N_A_LAYERS, DN_CONV, 2 * DN_HEADS * DN_DK + DN_HEADS * DN_DV), DN_CONV ** -0.5),
        "dn_a_log": jnp.log(jax.random.uniform(ks[4], (N_A_LAYERS, DN_HEADS), f32, 1.0, 16.0)),
        "dn_dt_bias": dt_bias,
        "dn_norm_w": 1.0 + nrm(ks[5], (N_A_LAYERS, DN_DV), 0.02),
        "dn_w_out": nrm(ks[6], (N_A_LAYERS, DN_HEADS * DN_DV, D), (DN_HEADS * DN_DV) ** -0.5 * DEEP_BETA),
        "w_kv_shared": jnp.concatenate([w_k, w_v], axis=1),
        "sw_w_q": nrm(ks[9], (N_B_LAYERS, D, SW_Q_HEADS * SW_HEAD_DIM), D ** -0.5),
        "sw_sinks": nrm(ks[10], (N_B_LAYERS, SW_Q_HEADS), 1.0),
        "sw_w_out": nrm(ks[11], (N_B_LAYERS, SW_Q_HEADS * SW_HEAD_DIM, D), (SW_Q_HEADS * SW_HEAD_DIM) ** -0.5 * DEEP_BETA),
        "ffn_w_gu": nrm(ks[12], (N_DENSE, D, 2 * D_FF), D ** -0.5),
        "ffn_w_down": nrm(ks[13], (N_DENSE, D_FF, D), D_FF ** -0.5 * DEEP_BETA),
        "moe_w_router": nrm(ks[14], (N_MOE, D, N_EXPERTS), D ** -0.5),
        "moe_w_gu": nrm(ks[15], (N_MOE, N_EXPERTS, D, 2 * D_EXPERT), D ** -0.5),
        "moe_w_down": nrm(ks[16], (N_MOE, N_EXPERTS, D_EXPERT, D), D_EXPERT ** -0.5 * DEEP_BETA),
        "ln_g": 1.0 + nrm(ks[17], (DEPTH, 2, D), 0.02),
        "ln_b": nrm(ks[18], (DEPTH, 2, D), 0.02),
    }


def math_log(v):
    return float(np.log(v))


def reference(x, dn_w_in, dn_conv_w, dn_a_log, dn_dt_bias, dn_norm_w, dn_w_out,
              w_kv_shared, sw_w_q, sw_sinks, sw_w_out, ffn_w_gu, ffn_w_down,
              moe_w_router, moe_w_gu, moe_w_down, ln_g, ln_b):
    k_sh, v_sh = None, None
    for layer in range(DEPTH):
        if layer < N_A_LAYERS:
            i = layer
            h = deltanet_mixer(x, dn_w_in[i], dn_conv_w[i], dn_a_log[i], dn_dt_bias[i],
                               dn_norm_w[i], dn_w_out[i])
        else:
            if layer == N_A_LAYERS:
                k_sh, v_sh = shared_kv(x, w_kv_shared)
            i = layer - N_A_LAYERS
            h = sliding_window_mixer(x, k_sh, v_sh, sw_w_q[i], sw_sinks[i], sw_w_out[i])
        x = layer_norm(DEEP_ALPHA * x + h, ln_g[layer, 0], ln_b[layer, 0])
        j = layer // 2
        if layer % 2 == 0:
            h = dense_swiglu(x, ffn_w_gu[j], ffn_w_down[j])
        else:
            h = moe_swiglu(x, moe_w_router[j], moe_w_gu[j], moe_w_down[j])
        x = layer_norm(DEEP_ALPHA * x + h, ln_g[layer, 1], ln_b[layer, 1])
    return x
```

```cpp
#include <hip/hip_runtime.h>
#include <cstdio>
#include <cstdint>

#define DI __device__ __forceinline__
typedef unsigned short bf16_t;
typedef short bf16x8 __attribute__((ext_vector_type(8)));
typedef float f32x4 __attribute__((ext_vector_type(4)));
typedef unsigned u32x4 __attribute__((ext_vector_type(4)));
typedef unsigned u32x2 __attribute__((ext_vector_type(2)));

constexpr int BATCH = 2, T = 8192, D = 1024, M = BATCH * T;
constexpr int DN_H = 8, DN_DK = 128, DN_W = 4112;
constexpr int SW_HQ = 16, SW_HK = 4, SW_HD = 64, SW_WIN = 128;
constexpr int DFF = 2816, NEXP = 8;
constexpr float DEEP_ALPHA = 1.4142135623730951f;
constexpr float LN_EPS = 1e-5f, RMS_EPS = 1e-6f;

constexpr size_t MiB = 1u << 20;
constexpr size_t WS_CTL = 0;
constexpr size_t WS_W_IN = 1 * MiB;
constexpr size_t WS_W_DNO = 9 * MiB;
constexpr size_t WS_W_FGU = 11 * MiB;
constexpr size_t WS_W_FDN = 22 * MiB;
constexpr size_t WS_W_QKV = 28 * MiB;
constexpr size_t WS_W_SWO = 31 * MiB;
constexpr size_t WS_W_MGU = 33 * MiB;
constexpr size_t WS_W_MDN = 121 * MiB;
constexpr size_t WS_XBF = 165 * MiB;
constexpr size_t WS_XRES = 197 * MiB;
constexpr size_t WS_R3 = 261 * MiB;
constexpr size_t WS_R4 = 389 * MiB;
constexpr size_t WS_OG = 645 * MiB;
constexpr size_t WS_SM = 677 * MiB;
constexpr size_t WS_END = 680 * MiB;
constexpr size_t SM_BA = 0;
constexpr size_t SM_BETA = 1 * MiB;
constexpr size_t SM_G = SM_BETA + 512 * 1024;
constexpr size_t SM_TOPI = 2 * MiB;
constexpr size_t SM_TOPW = SM_TOPI + 128 * 1024;

DI unsigned f2bf(float f) { unsigned u = __float_as_uint(f); return (u + 0x7fffu + ((u >> 16) & 1u)) >> 16; }
DI unsigned pk2(float lo, float hi) { return f2bf(lo) | (f2bf(hi) << 16); }
DI float bf2f(unsigned h) { return __uint_as_float(h << 16); }
DI float wave_sum(float v) {
#pragma unroll
    for (int o = 1; o < 64; o <<= 1) v += __shfl_xor(v, o);
    return v;
}
DI float wave_max(float v) {
#pragma unroll
    for (int o = 1; o < 64; o <<= 1) v = fmaxf(v, __shfl_xor(v, o));
    return v;
}
DI float silu_f(float x) { return x / (1.f + __expf(-x)); }

#define LAS __attribute__((address_space(3)))
DI void transpose_item(const float* W, int ld, int K, const float*  , bf16_t* WT, int k0, int n_src0, int row0, LAS float* scr, int lane) {
#pragma unroll 8
    for (int i = 0; i < 32; ++i) { const int kk = 2 * i + (lane >> 5); scr[kk * 33 + (lane & 31)] = W[(size_t)(k0 + kk) * ld + n_src0 + (lane & 31)]; }
    asm volatile("s_waitcnt vmcnt(0) lgkmcnt(0)" ::: "memory");
    const int c = lane & 7;
#pragma unroll
    for (int j = 0; j < 4; ++j) { const int n = (lane >> 3) + 8 * j; const LAS float* s = scr + (8 * c) * 33 + n;
        u32x4 o; o.x = pk2(s[0 * 33], s[1 * 33]); o.y = pk2(s[2 * 33], s[3 * 33]); o.z = pk2(s[4 * 33], s[5 * 33]); o.w = pk2(s[6 * 33], s[7 * 33]);
        *(u32x4*)(WT + (size_t)(row0 + n) * K + k0 + 8 * c) = o; }
    asm volatile("s_waitcnt lgkmcnt(0)" ::: "memory");
}
DI int gu_row(int n) { return n < DFF ? (n / 128) * 256 + (n % 128) : ((n - DFF) / 128) * 256 + 128 + ((n - DFF) % 128); }

struct Ptrs {
    const float *x, *dn_w_in, *dn_conv_w, *dn_a_log, *dn_dt_bias, *dn_norm_w, *dn_w_out, *w_kv, *sw_w_q, *sw_sinks, *sw_w_out,
        *ffn_w_gu, *ffn_w_down, *moe_w_router, *moe_w_gu, *moe_w_down, *ln_g, *ln_b;
    float* out; unsigned char* ws;
};

DI void prologue_items(const Ptrs& P, int gw, int ngw, int lane, LAS float* scr) {
    constexpr int I1 = 16 * 128, I2 = 16 * 32, I3 = 16 * 176, I4 = 44 * 32, I5 = 16 * 32, I6 = 16 * 16, I7 = 16 * 32, I8 = 8 * 16 * 176, I9 = 8 * 44 * 32;
    constexpr int NIT = I1 + I2 + I3 + I4 + I5 + I6 + I7 + I8 + I9;
    unsigned char* ws = P.ws;
    for (int it = gw; it < NIT; it += ngw) {
        int r = it;
        if (r < I1) { const int kb = r / 128, nb = r % 128; transpose_item(P.dn_w_in, DN_W, D, nullptr, (bf16_t*)(ws + WS_W_IN), 64 * kb, 32 * nb, 32 * nb, scr, lane); continue; } r -= I1;
        if (r < I2) { const int kb = r / 32, nb = r % 32; transpose_item(P.dn_w_out, D, D, nullptr, (bf16_t*)(ws + WS_W_DNO), 64 * kb, 32 * nb, 32 * nb, scr, lane); continue; } r -= I2;
        if (r < I3) { const int kb = r / 176, nb = r % 176; transpose_item(P.ffn_w_gu, 2 * DFF, D, nullptr, (bf16_t*)(ws + WS_W_FGU), 64 * kb, 32 * nb, gu_row(32 * nb), scr, lane); continue; } r -= I3;
        if (r < I4) { const int kb = r / 32, nb = r % 32; transpose_item(P.ffn_w_down, D, DFF, nullptr, (bf16_t*)(ws + WS_W_FDN), 64 * kb, 32 * nb, 32 * nb, scr, lane); continue; } r -= I4;
        if (r < I5) { const int kb = r / 32, nb = r % 32; transpose_item(P.sw_w_q, D, D, nullptr, (bf16_t*)(ws + WS_W_QKV), 64 * kb, 32 * nb, 32 * nb, scr, lane); continue; } r -= I5;
        if (r < I6) { const int kb = r / 16, nb = r % 16; transpose_item(P.w_kv, 512, D, nullptr, (bf16_t*)(ws + WS_W_QKV), 64 * kb, 32 * nb, 1024 + 32 * nb, scr, lane); continue; } r -= I6;
        if (r < I7) { const int kb = r / 32, nb = r % 32; transpose_item(P.sw_w_out, D, D, nullptr, (bf16_t*)(ws + WS_W_SWO), 64 * kb, 32 * nb, 32 * nb, scr, lane); continue; } r -= I7;
        if (r < I8) { const int e = r / (16 * 176), q = r % (16 * 176), kb = q / 176, nb = q % 176;
            transpose_item(P.moe_w_gu + (size_t)e * D * 2 * DFF, 2 * DFF, D, nullptr, (bf16_t*)(ws + WS_W_MGU) + (size_t)e * 2 * DFF * D, 64 * kb, 32 * nb, gu_row(32 * nb), scr, lane); continue; } r -= I8;
        { const int e = r / (44 * 32), q = r % (44 * 32), kb = q / 32, nb = q % 32;
            transpose_item(P.moe_w_down + (size_t)e * DFF * D, D, DFF, nullptr, (bf16_t*)(ws + WS_W_MDN) + (size_t)e * D * DFF, 64 * kb, 32 * nb, 32 * nb, scr, lane); }
    }
}

__global__ __launch_bounds__(256) void k_prologue(Ptrs P) {
    __shared__ float scr_all[4][64 * 33];
    const int lane = threadIdx.x & 63, wid = threadIdx.x >> 6;
    const int gw = blockIdx.x * 4 + wid, ngw = gridDim.x * 4;
    prologue_items(P, gw, ngw, lane, (LAS float*)scr_all[wid]);
    bf16_t* xb = (bf16_t*)(P.ws + WS_XBF);
    for (size_t i = (size_t)blockIdx.x * 256 + threadIdx.x; i < (size_t)M * D / 8; i += (size_t)gridDim.x * 256) {
        const f32x4 a = *(const f32x4*)(P.x + i * 8), b = *(const f32x4*)(P.x + i * 8 + 4);
        u32x4 o; o.x = pk2(a.x, a.y); o.y = pk2(a.z, a.w); o.z = pk2(b.x, b.y); o.w = pk2(b.z, b.w);
        *(u32x4*)(xb + i * 8) = o;
    }
}

template <bool OUT_BF16>
__global__ __launch_bounds__(256) void k_gemm_simple(const bf16_t* __restrict__ A, const bf16_t* __restrict__ Bt, void* __restrict__ Cv, int K, int ldc) {
    const int lane = threadIdx.x & 63, wid = threadIdx.x >> 6, wm = wid >> 1, wn = wid & 1;
    const int m0 = blockIdx.y * 128 + wm * 64, n0 = blockIdx.x * 128 + wn * 64;
    const int r = lane & 15, q = lane >> 4;
    f32x4 acc[4][4];
#pragma unroll
    for (int i = 0; i < 4; ++i)
#pragma unroll
        for (int j = 0; j < 4; ++j) acc[i][j] = (f32x4){0.f, 0.f, 0.f, 0.f};
    const bf16_t* Ap = A + (size_t)(m0 + r) * K + q * 8;
    const bf16_t* Bp = Bt + (size_t)(n0 + r) * K + q * 8;
    for (int k0 = 0; k0 < K; k0 += 32) {
        bf16x8 a[4], b[4];
#pragma unroll
        for (int i = 0; i < 4; ++i) a[i] = *(const bf16x8*)(Ap + (size_t)i * 16 * K + k0);
#pragma unroll
        for (int j = 0; j < 4; ++j) b[j] = *(const bf16x8*)(Bp + (size_t)j * 16 * K + k0);
#pragma unroll
        for (int i = 0; i < 4; ++i)
#pragma unroll
            for (int j = 0; j < 4; ++j) acc[i][j] = __builtin_amdgcn_mfma_f32_16x16x32_bf16(b[j], a[i], acc[i][j], 0, 0, 0);
    }
#pragma unroll
    for (int i = 0; i < 4; ++i)
#pragma unroll
        for (int j = 0; j < 4; ++j) {
            const size_t off = (size_t)(m0 + 16 * i + r) * ldc + n0 + 16 * j + 4 * q;
            if (OUT_BF16) { u32x2 o; o.x = pk2(acc[i][j][0], acc[i][j][1]); o.y = pk2(acc[i][j][2], acc[i][j][3]); *(u32x2*)((bf16_t*)Cv + off) = o; }
            else *(f32x4*)((float*)Cv + off) = acc[i][j];
        }
}

__global__ __launch_bounds__(256) void k_ba(Ptrs P) {
    const int lane = threadIdx.x & 63, gw = blockIdx.x * 4 + (threadIdx.x >> 6);
    if (gw >= M) return;
    float acc[16];
#pragma unroll
    for (int j = 0; j < 16; ++j) acc[j] = 0.f;
    for (int i = 0; i < 16; ++i) { const int k = lane + 64 * i; const float xv = P.x[(size_t)gw * D + k]; const float* w = P.dn_w_in + (size_t)k * DN_W + 4096;
#pragma unroll
        for (int j4 = 0; j4 < 4; ++j4) { const f32x4 wv = *(const f32x4*)(w + 4 * j4); acc[4 * j4] += xv * wv.x; acc[4 * j4 + 1] += xv * wv.y; acc[4 * j4 + 2] += xv * wv.z; acc[4 * j4 + 3] += xv * wv.w; } }
    float* ba = (float*)(P.ws + WS_SM + SM_BA);
#pragma unroll
    for (int j = 0; j < 16; ++j) { const float s = wave_sum(acc[j]); if (lane == 0) ba[(size_t)gw * 16 + j] = s; }
}

__global__ __launch_bounds__(256) void k_dn_prep(Ptrs P) {
    const int lane = threadIdx.x & 63, gw = blockIdx.x * 4 + (threadIdx.x >> 6);
    const int m = gw >> 3, h = gw & 7, t = m % T;
    const bf16_t* raw = (const bf16_t*)(P.ws + WS_R3);
    float* qf = (float*)(P.ws + WS_R4); float* kf = qf + (size_t)M * D; float* vf = kf + (size_t)M * D;
    float val[3][2];
#pragma unroll
    for (int s = 0; s < 3; ++s)
#pragma unroll
        for (int u = 0; u < 2; ++u) {
            const int c = s * 1024 + h * 128 + lane + 64 * u; float a = 0.f;
#pragma unroll
            for (int i = 0; i < 4; ++i) { const int tt = t - 3 + i; if (tt >= 0) a += bf2f(raw[(size_t)(m - 3 + i) * 4096 + c]) * P.dn_conv_w[i * 3072 + c]; }
            val[s][u] = silu_f(a);
        }
    const float qn = wave_sum(val[0][0] * val[0][0] + val[0][1] * val[0][1]), kn = wave_sum(val[1][0] * val[1][0] + val[1][1] * val[1][1]);
    const float qs = rsqrtf(qn + RMS_EPS) * 0.08838834764831845f, ks = rsqrtf(kn + RMS_EPS);
#pragma unroll
    for (int u = 0; u < 2; ++u) { const size_t o = (size_t)m * D + h * 128 + lane + 64 * u; qf[o] = val[0][u] * qs; kf[o] = val[1][u] * ks; vf[o] = val[2][u]; }
    if (lane == 0) {
        const float* ba = (const float*)(P.ws + WS_SM + SM_BA) + (size_t)m * 16;
        const float bl = ba[h], al = ba[8 + h] + P.dn_dt_bias[h];
        const float sp = al > 20.f ? al : log1pf(__expf(al));
        ((float*)(P.ws + WS_SM + SM_BETA))[(size_t)m * 8 + h] = 1.f / (1.f + __expf(-bl));
        ((float*)(P.ws + WS_SM + SM_G))[(size_t)m * 8 + h] = -__expf(P.dn_a_log[h]) * sp;
    }
}

__global__ __launch_bounds__(64) void k_dn_recurrent(Ptrs P) {
    const int lane = threadIdx.x, bh = blockIdx.x >> 1, half = blockIdx.x & 1, b = bh >> 3, h = bh & 7, col = half * 64 + lane;
    const float* qf = (const float*)(P.ws + WS_R4); const float* kf = qf + (size_t)M * D; const float* vf = kf + (size_t)M * D; float* of = (float*)(vf + (size_t)M * D);
    const float* beta = (const float*)(P.ws + WS_SM + SM_BETA); const float* gg = (const float*)(P.ws + WS_SM + SM_G);
    __shared__ __attribute__((aligned(16))) float sk[128], sq[128];
    float S[128];
#pragma unroll
    for (int d = 0; d < 128; ++d) S[d] = 0.f;
    for (int t = 0; t < T; ++t) {
        const size_t m = (size_t)b * T + t, base = m * D + h * 128;
        sk[lane] = kf[base + lane]; sk[lane + 64] = kf[base + lane + 64]; sq[lane] = qf[base + lane]; sq[lane + 64] = qf[base + lane + 64];
        const float vv = vf[base + col], bt = beta[m * 8 + h], eg = __expf(gg[m * 8 + h]);
        __syncthreads();
        float p0 = 0.f, p1 = 0.f, p2 = 0.f, p3 = 0.f;
#pragma unroll
        for (int d = 0; d < 128; d += 4) { const f32x4 kv = *(const f32x4*)(sk + d); p0 += kv.x * S[d]; p1 += kv.y * S[d + 1]; p2 += kv.z * S[d + 2]; p3 += kv.w * S[d + 3]; }
        const float kS = (p0 + p1) + (p2 + p3), c = bt * (vv - eg * kS);
        float o0 = 0.f, o1 = 0.f, o2 = 0.f, o3 = 0.f;
#pragma unroll
        for (int d = 0; d < 128; d += 4) { const f32x4 kv = *(const f32x4*)(sk + d), qv = *(const f32x4*)(sq + d);
            S[d] = eg * S[d] + kv.x * c; S[d + 1] = eg * S[d + 1] + kv.y * c; S[d + 2] = eg * S[d + 2] + kv.z * c; S[d + 3] = eg * S[d + 3] + kv.w * c;
            o0 += qv.x * S[d]; o1 += qv.y * S[d + 1]; o2 += qv.z * S[d + 2]; o3 += qv.w * S[d + 3]; }
        of[base + col] = (o0 + o1) + (o2 + o3);
        __syncthreads();
    }
}

__global__ __launch_bounds__(256) void k_dn_gate(Ptrs P) {
    const int lane = threadIdx.x & 63, gw = blockIdx.x * 4 + (threadIdx.x >> 6);
    const int m = gw >> 3, h = gw & 7;
    const float* of = (const float*)(P.ws + WS_R4) + (size_t)3 * M * D;
    const bf16_t* raw = (const bf16_t*)(P.ws + WS_R3);
    bf16_t* og = (bf16_t*)(P.ws + WS_OG);
    const float a0 = of[(size_t)m * D + h * 128 + lane], a1 = of[(size_t)m * D + h * 128 + lane + 64];
    const float rs = rsqrtf(wave_sum(a0 * a0 + a1 * a1) * (1.f / 128.f) + RMS_EPS);
    const float z0 = bf2f(raw[(size_t)m * 4096 + 3072 + h * 128 + lane]), z1 = bf2f(raw[(size_t)m * 4096 + 3072 + h * 128 + lane + 64]);
    og[(size_t)m * D + h * 128 + lane] = (bf16_t)f2bf(a0 * rs * P.dn_norm_w[lane] * silu_f(z0));
    og[(size_t)m * D + h * 128 + lane + 64] = (bf16_t)f2bf(a1 * rs * P.dn_norm_w[lane + 64] * silu_f(z1));
}

__global__ __launch_bounds__(256) void k_ln(const float* xres, const float* hbuf, const float* g, const float* bsh, float* outf, bf16_t* outb) {
    const int lane = threadIdx.x & 63, m = blockIdx.x * 4 + (threadIdx.x >> 6);
    f32x4 v[4]; float s = 0.f;
#pragma unroll
    for (int j = 0; j < 4; ++j) { const size_t o = (size_t)m * D + 256 * j + 4 * lane; const f32x4 a = *(const f32x4*)(xres + o), hh = *(const f32x4*)(hbuf + o);
        v[j] = a * DEEP_ALPHA + hh; s += (v[j].x + v[j].y) + (v[j].z + v[j].w); }
    const float mean = wave_sum(s) * (1.f / D); float s2 = 0.f;
#pragma unroll
    for (int j = 0; j < 4; ++j) { v[j] = v[j] - mean; s2 += (v[j].x * v[j].x + v[j].y * v[j].y) + (v[j].z * v[j].z + v[j].w * v[j].w); }
    const float rstd = rsqrtf(wave_sum(s2) * (1.f / D) + LN_EPS);
#pragma unroll
    for (int j = 0; j < 4; ++j) { const int c = 256 * j + 4 * lane; const size_t o = (size_t)m * D + c;
        const f32x4 y = v[j] * rstd * *(const f32x4*)(g + c) + *(const f32x4*)(bsh + c);
        *(f32x4*)(outf + o) = y;
        if (outb) { u32x2 w; w.x = pk2(y.x, y.y); w.y = pk2(y.z, y.w); *(u32x2*)(outb + o) = w; } }
}

__global__ __launch_bounds__(256) void k_swiglu(const bf16_t* C, bf16_t* Hh) {
    const size_t i = (size_t)blockIdx.x * 256 + threadIdx.x;
    if (i >= (size_t)M * DFF) return;
    const size_t m = i / DFF; const int c = (int)(i % DFF);
    const float gt = bf2f(C[m * 2 * DFF + (c / 128) * 256 + (c % 128)]), up = bf2f(C[m * 2 * DFF + (c / 128) * 256 + 128 + (c % 128)]);
    Hh[i] = (bf16_t)f2bf(silu_f(gt) * up);
}

__global__ __launch_bounds__(256) void k_attn_naive(Ptrs P) {
    const int lane = threadIdx.x & 63, gw = blockIdx.x * 4 + (threadIdx.x >> 6);
    const int m = gw >> 4, hq = gw & 15, t = m % T, kvh = hq >> 2;
    const bf16_t* qkv = (const bf16_t*)(P.ws + WS_R3);
    bf16_t* ao = (bf16_t*)(P.ws + WS_R3 + 48 * MiB);
    const float slope = exp2f(-0.5f * (float)(hq + 1)), sink = P.sw_sinks[hq];
    float qv[64];
#pragma unroll
    for (int d8 = 0; d8 < 8; ++d8) { const bf16x8 v = *(const bf16x8*)(qkv + (size_t)m * 1536 + hq * 64 + d8 * 8);
#pragma unroll
        for (int e = 0; e < 8; ++e) qv[d8 * 8 + e] = bf2f((unsigned short)v[e]); }
    float sc[2];
#pragma unroll
    for (int u = 0; u < 2; ++u) { const int dist = lane + 64 * u; float s = -INFINITY;
        if (t - dist >= 0) { const bf16_t* kr = qkv + (size_t)(m - dist) * 1536 + 1024 + kvh * 64; float dot = 0.f;
#pragma unroll
            for (int d8 = 0; d8 < 8; ++d8) { const bf16x8 v = *(const bf16x8*)(kr + d8 * 8);
#pragma unroll
                for (int e = 0; e < 8; ++e) dot += qv[d8 * 8 + e] * bf2f((unsigned short)v[e]); }
            s = dot * 0.125f - slope * (float)dist; }
        sc[u] = s; }
    const float mx = fmaxf(wave_max(fmaxf(sc[0], sc[1])), sink);
    const float p0 = __expf(sc[0] - mx), p1 = __expf(sc[1] - mx);
    const float den = wave_sum(p0 + p1) + __expf(sink - mx);
    float o = 0.f;
    for (int j = 0; j < 64; ++j) { const float pj = __shfl(p0, j); if (t - j >= 0) o += pj * bf2f(qkv[(size_t)(m - j) * 1536 + 1280 + kvh * 64 + lane]); }
    for (int j = 0; j < 64; ++j) { const float pj = __shfl(p1, j); if (t - j - 64 >= 0) o += pj * bf2f(qkv[(size_t)(m - j - 64) * 1536 + 1280 + kvh * 64 + lane]); }
    ao[(size_t)m * D + hq * 64 + lane] = (bf16_t)f2bf(o / den);
}

__global__ __launch_bounds__(256) void k_router(Ptrs P) {
    const int lane = threadIdx.x & 63, m = blockIdx.x * 4 + (threadIdx.x >> 6);
    const float* xr = (const float*)(P.ws + WS_XRES) + (size_t)m * D;
    float acc[8];
#pragma unroll
    for (int e = 0; e < 8; ++e) acc[e] = 0.f;
    for (int i = 0; i < 16; ++i) { const int k = lane + 64 * i; const float xv = xr[k]; const f32x4 w0 = *(const f32x4*)(P.moe_w_router + k * 8), w1 = *(const f32x4*)(P.moe_w_router + k * 8 + 4);
        acc[0] += xv * w0.x; acc[1] += xv * w0.y; acc[2] += xv * w0.z; acc[3] += xv * w0.w; acc[4] += xv * w1.x; acc[5] += xv * w1.y; acc[6] += xv * w1.z; acc[7] += xv * w1.w; }
#pragma unroll
    for (int e = 0; e < 8; ++e) acc[e] = wave_sum(acc[e]);
    if (lane == 0) {
        int i1 = 0; float v1 = acc[0];
#pragma unroll
        for (int e = 1; e < 8; ++e) if (acc[e] > v1) { v1 = acc[e]; i1 = e; }
        int i2 = -1; float v2 = -INFINITY;
#pragma unroll
        for (int e = 0; e < 8; ++e) if (e != i1 && acc[e] > v2) { v2 = acc[e]; i2 = e; }
        const float w1 = 1.f / (1.f + __expf(v2 - v1));
        int* ti = (int*)(P.ws + WS_SM + SM_TOPI); float* tw = (float*)(P.ws + WS_SM + SM_TOPW);
        ti[2 * m] = i1; ti[2 * m + 1] = i2; tw[2 * m] = w1; tw[2 * m + 1] = 1.f - w1;
    }
}
__global__ __launch_bounds__(256) void k_moe_acc(Ptrs P, const float* y, float* acc, int e) {
    const size_t i = ((size_t)blockIdx.x * 256 + threadIdx.x) * 4;
    const size_t m = i / D;
    const int* ti = (const int*)(P.ws + WS_SM + SM_TOPI); const float* tw = (const float*)(P.ws + WS_SM + SM_TOPW);
    const float gt = (ti[2 * m] == e ? tw[2 * m] : 0.f) + (ti[2 * m + 1] == e ? tw[2 * m + 1] : 0.f);
    f32x4 a = (e == 0) ? (f32x4){0.f, 0.f, 0.f, 0.f} : *(const f32x4*)(acc + i);
    a = a + *(const f32x4*)(y + i) * gt;
    *(f32x4*)(acc + i) = a;
}

static void gemm(hipStream_t st, const void* A, const void* Bt, void* C, int Mm, int N, int K, int ldc, bool obf) {
    dim3 g(N / 128, Mm / 128);
    if (obf) hipLaunchKernelGGL(k_gemm_simple<true>, g, dim3(256), 0, st, (const bf16_t*)A, (const bf16_t*)Bt, C, K, ldc);
    else hipLaunchKernelGGL(k_gemm_simple<false>, g, dim3(256), 0, st, (const bf16_t*)A, (const bf16_t*)Bt, C, K, ldc);
}

extern "C" void kernel_launch(void* const* d_in, const int* in_sizes, int n_in, void* d_out, int out_size, void* d_ws, size_t ws_size, hipStream_t stream) {
    if (n_in != 18 || ws_size < WS_END) { fprintf(stderr, "kernel_launch: unexpected n_in %d / ws %zu\n", n_in, ws_size); return; }
    Ptrs P{};
    P.x = (const float*)d_in[0]; P.dn_w_in = (const float*)d_in[1]; P.dn_conv_w = (const float*)d_in[2]; P.dn_a_log = (const float*)d_in[3]; P.dn_dt_bias = (const float*)d_in[4];
    P.dn_norm_w = (const float*)d_in[5]; P.dn_w_out = (const float*)d_in[6]; P.w_kv = (const float*)d_in[7]; P.sw_w_q = (const float*)d_in[8]; P.sw_sinks = (const float*)d_in[9];
    P.sw_w_out = (const float*)d_in[10]; P.ffn_w_gu = (const float*)d_in[11]; P.ffn_w_down = (const float*)d_in[12]; P.moe_w_router = (const float*)d_in[13];
    P.moe_w_gu = (const float*)d_in[14]; P.moe_w_down = (const float*)d_in[15]; P.ln_g = (const float*)d_in[16]; P.ln_b = (const float*)d_in[17];
    P.out = (float*)d_out; P.ws = (unsigned char*)d_ws;
    unsigned char* ws = P.ws;
    float* xres = (float*)(ws + WS_XRES); bf16_t* xbf = (bf16_t*)(ws + WS_XBF);
    hipLaunchKernelGGL(k_prologue, dim3(1024), dim3(256), 0, stream, P);
    gemm(stream, xbf, ws + WS_W_IN, ws + WS_R3, M, 4096, D, 4096, true);
    hipLaunchKernelGGL(k_ba, dim3(M / 4), dim3(256), 0, stream, P);
    hipLaunchKernelGGL(k_dn_prep, dim3(M * 8 / 4), dim3(256), 0, stream, P);
    hipLaunchKernelGGL(k_dn_recurrent, dim3(32), dim3(64), 0, stream, P);
    hipLaunchKernelGGL(k_dn_gate, dim3(M * 8 / 4), dim3(256), 0, stream, P);
    gemm(stream, ws + WS_OG, ws + WS_W_DNO, ws + WS_R3, M, D, D, D, false);
    hipLaunchKernelGGL(k_ln, dim3(M / 4), dim3(256), 0, stream, P.x, (const float*)(ws + WS_R3), P.ln_g, P.ln_b, xres, xbf);
    gemm(stream, xbf, ws + WS_W_FGU, ws + WS_R4, M, 2 * DFF, D, 2 * DFF, true);
    hipLaunchKernelGGL(k_swiglu, dim3((unsigned)(((size_t)M * DFF + 255) / 256)), dim3(256), 0, stream, (const bf16_t*)(ws + WS_R4), (bf16_t*)(ws + WS_R3));
    gemm(stream, ws + WS_R3, ws + WS_W_FDN, ws + WS_R4, M, D, DFF, D, false);
    hipLaunchKernelGGL(k_ln, dim3(M / 4), dim3(256), 0, stream, (const float*)xres, (const float*)(ws + WS_R4), P.ln_g + D, P.ln_b + D, xres, xbf);
    gemm(stream, xbf, ws + WS_W_QKV, ws + WS_R3, M, 1536, D, 1536, true);
    hipLaunchKernelGGL(k_attn_naive, dim3(M * 16 / 4), dim3(256), 0, stream, P);
    gemm(stream, ws + WS_R3 + 48 * MiB, ws + WS_W_SWO, ws + WS_R4, M, D, D, D, false);
    hipLaunchKernelGGL(k_ln, dim3(M / 4), dim3(256), 0, stream, (const float*)xres, (const float*)(ws + WS_R4), P.ln_g + 2 * D, P.ln_b + 2 * D, xres, xbf);
    hipLaunchKernelGGL(k_router, dim3(M / 4), dim3(256), 0, stream, P);
    for (int e = 0; e < NEXP; ++e) {
        gemm(stream, xbf, ws + WS_W_MGU + (size_t)e * 2 * DFF * D * 2, ws + WS_R4, M, 2 * DFF, D, 2 * DFF, true);
        hipLaunchKernelGGL(k_swiglu, dim3((unsigned)(((size_t)M * DFF + 255) / 256)), dim3(256), 0, stream, (const bf16_t*)(ws + WS_R4), (bf16_t*)(ws + WS_R3));
        gemm(stream, ws + WS_R3, ws + WS_W_MDN + (size_t)e * D * DFF * 2, ws + WS_R4 + 176 * MiB, M, D, DFF, D, false);
        hipLaunchKernelGGL(k_moe_acc, dim3(M * D / 4 / 256), dim3(256), 0, stream, P, (const float*)(ws + WS_R4 + 176 * MiB), P.out, e);
    }
    hipLaunchKernelGGL(k_ln, dim3(M / 4), dim3(256), 0, stream, (const float*)xres, (const float*)P.out, P.ln_g + 3 * D, P.ln_b + 3 * D, P.out, (bf16_t*)nullptr);
}
```
